# Optimizing an MI355X kernel written in HIP

```python
import math
import jax, jax.numpy as jnp
from jax import lax
import numpy as np

D_MODEL = 2048
BATCH = 16
SEQ = 2048
DEPTH = 4
DEC_BATCH = 1
DEC_SEQ = 8192
PAST_LEN = 128

HEAD_DIM = 128
N_HEADS_A = 8
N_KV_A = 2
GROUP_A = N_HEADS_A // N_KV_A
WINDOW = 128
BLOCK = 128
N_BUCKETS = 32
MAX_DISTANCE = 128
N_HEADS_B = 8
Q_LORA = 512
KV_LORA = 256
D_NOPE = 128
D_ROPE = 64
D_V = 128
ROPE_THETA = 10000.0
MIX_WIDTH = N_HEADS_A * HEAD_DIM + N_HEADS_B * D_V
D_FF = 5632
CONV_WIDTH = 3
ALPHA = (2 * DEPTH) ** 0.25
BETA = (8 * DEPTH) ** -0.25
LN_EPS = 1e-5
RMS_EPS = 1e-6
NEG_INF = -1e30
SPLITS = (N_HEADS_A * HEAD_DIM, N_KV_A * HEAD_DIM, N_KV_A * HEAD_DIM, Q_LORA, KV_LORA, D_ROPE)
IN_COLS = N_HEADS_A * HEAD_DIM + 2 * N_KV_A * HEAD_DIM + Q_LORA + KV_LORA + D_ROPE

kernel_name = "hymba_swa_mla_deepnorm_encoder"


def layer_norm(x, g, b):
    xf = x.astype(jnp.float32)
    mu = xf.mean(-1, keepdims=True)
    var = jnp.square(xf - mu).mean(-1, keepdims=True)
    y = (xf - mu) * lax.rsqrt(var + LN_EPS) * g.astype(jnp.float32) + b.astype(jnp.float32)
    return y.astype(x.dtype)


def rms_norm(x, g):
    xf = x.astype(jnp.float32)
    y = xf * lax.rsqrt(jnp.mean(xf * xf, -1, keepdims=True) + RMS_EPS) * g.astype(jnp.float32)
    return y.astype(x.dtype)


def t5_bucket(rel):
    half = N_BUCKETS // 2
    max_exact = half // 2
    ret = (rel > 0).astype(jnp.int32) * half
    n = jnp.abs(rel)
    large = max_exact + (jnp.log(jnp.maximum(n, 1).astype(jnp.float32) / max_exact)
                         / math.log(MAX_DISTANCE / max_exact) * (half - max_exact)).astype(jnp.int32)
    large = jnp.minimum(large, half - 1)
    return ret + jnp.where(n < max_exact, n, large)


def rope_tables(S, dtype):
    inv = 1.0 / (ROPE_THETA ** (jnp.arange(0, D_ROPE, 2, dtype=jnp.float32) / D_ROPE))
    ang = jnp.arange(S, dtype=jnp.float32)[:, None] * inv[None, :]
    return jnp.cos(ang).astype(dtype), jnp.sin(ang).astype(dtype)


def apply_rope(x, cos, sin):
    x1, x2 = jnp.split(x, 2, axis=-1)
    return jnp.concatenate([x1 * cos - x2 * sin, x2 * cos + x1 * sin], axis=-1)


def window_gqa(q, k, v, sink, rel_bias):
    B, S = q.shape[0], q.shape[1]
    nb = S // BLOCK
    pad = ((0, 0), (BLOCK, BLOCK), (0, 0), (0, 0))
    kp = jnp.pad(k, pad).reshape(B, nb + 2, BLOCK, N_KV_A, HEAD_DIM)
    vp = jnp.pad(v, pad).reshape(B, nb + 2, BLOCK, N_KV_A, HEAD_DIM)
    kw = jnp.concatenate([kp[:, :-2], kp[:, 1:-1], kp[:, 2:]], axis=2)
    vw = jnp.concatenate([vp[:, :-2], vp[:, 1:-1], vp[:, 2:]], axis=2)
    qb = q.reshape(B, nb, BLOCK, N_KV_A, GROUP_A, HEAD_DIM)
    s = jnp.einsum('bnqhgd,bnkhd->bnhgqk', qb, kw).astype(jnp.float32) * (HEAD_DIM ** -0.5)
    qi = jnp.arange(BLOCK, dtype=jnp.int32)
    ki = jnp.arange(3 * BLOCK, dtype=jnp.int32)
    rel = ki[None, :] - BLOCK - qi[:, None]
    bias = rel_bias.astype(jnp.float32)[t5_bucket(rel)]
    bias = bias.transpose(2, 0, 1).reshape(N_KV_A, GROUP_A, BLOCK, 3 * BLOCK)
    kpos = jnp.arange(nb, dtype=jnp.int32)[:, None] * BLOCK - BLOCK + ki[None, :]
    valid = (jnp.abs(rel) <= WINDOW)[None] & ((kpos >= 0) & (kpos < S))[:, None, :]
    s = jnp.where(valid[None, :, None, None], s + bias[None, None], NEG_INF)
    sk = jnp.broadcast_to(sink.astype(jnp.float32).reshape(N_KV_A, GROUP_A, 1, 1), s.shape[:-1] + (1,))
    p = jax.nn.softmax(jnp.concatenate([s, sk], axis=-1), axis=-1)[..., :-1]
    o = jnp.einsum('bnhgqk,bnkhd->bnqhgd', p.astype(v.dtype), vw)
    return o.reshape(B, S, N_HEADS_A * HEAD_DIM)


def latent_attention(c_q, c_kv, k_rope, q_norm_g, w_uq, kv_norm_g, w_ukv):
    B, S = c_q.shape[0], c_q.shape[1]
    nb = S // BLOCK
    q = (rms_norm(c_q, q_norm_g) @ w_uq).reshape(B, S, N_HEADS_B, D_NOPE + D_ROPE)
    kv = (rms_norm(c_kv, kv_norm_g) @ w_ukv).reshape(B, S, N_HEADS_B, D_NOPE + D_V)
    q_nope, q_rope = q[..., :D_NOPE], q[..., D_NOPE:]
    k_nope, v = kv[..., :D_NOPE], kv[..., D_NOPE:]
    cos, sin = rope_tables(S, q.dtype)
    q_rope = apply_rope(q_rope, cos[:, None, :], sin[:, None, :])
    k_rope = apply_rope(k_rope, cos, sin)
    scale = (D_NOPE + D_ROPE) ** -0.5
    qn = q_nope.reshape(B, nb, BLOCK, N_HEADS_B, D_NOPE).transpose(1, 0, 2, 3, 4)
    qr = q_rope.reshape(B, nb, BLOCK, N_HEADS_B, D_ROPE).transpose(1, 0, 2, 3, 4)

    def query_block(args):
        qn_b, qr_b = args
        s = (jnp.einsum('bqhd,bkhd->bhqk', qn_b, k_nope)
             + jnp.einsum('bqhd,bkd->bhqk', qr_b, k_rope)).astype(jnp.float32) * scale
        p = jax.nn.softmax(s, axis=-1)
        return jnp.einsum('bhqk,bkhd->bqhd', p.astype(v.dtype), v)

    o = lax.map(query_block, (qn, qr))
    return o.transpose(1, 0, 2, 3, 4).reshape(B, S, N_HEADS_B * D_V)


def conv_glu(x, w_up, conv_w, conv_b, w_down):
    u = x @ w_up
    up = jnp.pad(u, ((0, 0), (1, 1), (0, 0)))
    u = up[:, :-2] * conv_w[0] + up[:, 1:-1] * conv_w[1] + up[:, 2:] * conv_w[2] + conv_b
    g, val = u[..., :D_FF], u[..., D_FF:]
    return (jax.nn.silu(g) * val) @ w_down


def encoder_layer(x, rel_bias, w_in, sink, q_norm_g, w_uq, kv_norm_g, w_ukv, w_o,
                  ln1_g, ln1_b, w_up, conv_w, conv_b, w_down, ln2_g, ln2_b):
    B, S = x.shape[0], x.shape[1]
    h = x @ w_in
    cuts = [int(c) for c in np.cumsum(SPLITS)[:-1]]
    qa, ka, va, c_q, c_kv, k_rope = jnp.split(h, cuts, axis=-1)
    oa = window_gqa(qa.reshape(B, S, N_HEADS_A, HEAD_DIM),
                    ka.reshape(B, S, N_KV_A, HEAD_DIM),
                    va.reshape(B, S, N_KV_A, HEAD_DIM), sink, rel_bias)
    ob = latent_attention(c_q, c_kv, k_rope, q_norm_g, w_uq, kv_norm_g, w_ukv)
    attn = jnp.concatenate([oa, ob], axis=-1) @ w_o
    x = layer_norm(ALPHA * x + attn, ln1_g, ln1_b)
    x = layer_norm(ALPHA * x + conv_glu(x, w_up, conv_w, conv_b, w_down), ln2_g, ln2_b)
    return x


def run_trunk(x, rel_bias, w_in, sink, q_norm_g, w_uq, kv_norm_g, w_ukv, w_o,
              ln1_g, ln1_b, w_up, conv_w, conv_b, w_down, ln2_g, ln2_b):
    for l in range(DEPTH):
        x = encoder_layer(x, rel_bias, w_in[l], sink[l], q_norm_g[l], w_uq[l], kv_norm_g[l],
                          w_ukv[l], w_o[l], ln1_g[l], ln1_b[l], w_up[l], conv_w[l], conv_b[l],
                          w_down[l], ln2_g[l], ln2_b[l])
    return x


def setup_inputs(seed: int = 0) -> dict:
    key = jax.random.key(seed)
    ks = jax.random.split(key, 20)
    f32 = jnp.float32
    nrm = lambda k, shape, scale: jax.random.normal(k, shape, f32) * scale
    col_scale = jnp.concatenate([
        jnp.ones((SPLITS[0] + SPLITS[1],), f32),
        jnp.full((SPLITS[2],), BETA, f32),
        jnp.ones((SPLITS[3] + SPLITS[4] + SPLITS[5],), f32)])
    w_in = nrm(ks[2], (DEPTH, D_MODEL, IN_COLS), D_MODEL ** -0.5) * col_scale
    ukv_scale = jnp.concatenate([jnp.ones((D_NOPE,), f32), jnp.full((D_V,), BETA, f32)])
    w_ukv = (nrm(ks[6], (DEPTH, KV_LORA, N_HEADS_B, D_NOPE + D_V), KV_LORA ** -0.5)
             * ukv_scale).reshape(DEPTH, KV_LORA, N_HEADS_B * (D_NOPE + D_V))
    return {
        "x_prompt": nrm(ks[0], (BATCH, SEQ, D_MODEL), 1.0),
        "x_sample": nrm(ks[1], (DEC_BATCH, DEC_SEQ, D_MODEL), 1.0),
        "rel_bias": nrm(ks[3], (N_BUCKETS, N_HEADS_A), 0.5),
        "w_in": w_in,
        "sink": nrm(ks[4], (DEPTH, N_HEADS_A), 0.5),
        "q_norm_g": 1.0 + nrm(ks[5], (DEPTH, Q_LORA), 0.02),
        "w_uq": nrm(ks[7], (DEPTH, Q_LORA, N_HEADS_B * (D_NOPE + D_ROPE)), Q_LORA ** -0.5),
        "kv_norm_g": 1.0 + nrm(ks[8], (DEPTH, KV_LORA), 0.02),
        "w_ukv": w_ukv,
        "w_o": nrm(ks[9], (DEPTH, MIX_WIDTH, D_MODEL), BETA * MIX_WIDTH ** -0.5),
        "ln1_g": 1.0 + nrm(ks[10], (DEPTH, D_MODEL), 0.02),
        "ln1_b": nrm(ks[11], (DEPTH, D_MODEL), 0.02),
        "w_up": nrm(ks[12], (DEPTH, D_MODEL, 2 * D_FF), BETA * D_MODEL ** -0.5),
        "conv_w": nrm(ks[13], (DEPTH, CONV_WIDTH, 2 * D_FF), CONV_WIDTH ** -0.5),
        "conv_b": nrm(ks[14], (DEPTH, 2 * D_FF), 0.01),
        "w_down": nrm(ks[15], (DEPTH, D_FF, D_MODEL), BETA * D_FF ** -0.5),
        "ln2_g": 1.0 + nrm(ks[16], (DEPTH, D_MODEL), 0.02),
        "ln2_b": nrm(ks[17], (DEPTH, D_MODEL), 0.02),
    }


def reference(x_prompt, x_sample, rel_bias, w_in, sink, q_norm_g, w_uq, kv_norm_g, w_ukv, w_o,
              ln1_g, ln1_b, w_up, conv_w, conv_b, w_down, ln2_g, ln2_b):
    y_prompt = run_trunk(x_prompt, rel_bias, w_in, sink, q_norm_g, w_uq, kv_norm_g, w_ukv, w_o,
                         ln1_g, ln1_b, w_up, conv_w, conv_b, w_down, ln2_g, ln2_b)
    y_sample = run_trunk(x_sample, rel_bias, w_in, sink, q_norm_g, w_uq, kv_norm_g, w_ukv, w_o,
                         ln1_g, ln1_b, w_up, conv_w, conv_b, w_down, ln2_g, ln2_b)
    return (y_prompt, y_sample)
```

```cpp
#include <hip/hip_runtime.h>
#include <hip/hip_cooperative_groups.h>
#include <cstdio>
#include <cstdint>
namespace cg = cooperative_groups;

#define LAS __attribute__((address_space(3)))
#define DI __device__ __forceinline__
typedef unsigned short bf16_t;
typedef short bf16x8 __attribute__((ext_vector_type(8)));
typedef short s16x4 __attribute__((ext_vector_type(4)));
typedef float f32x4 __attribute__((ext_vector_type(4)));
typedef float f32x16 __attribute__((ext_vector_type(16)));
typedef unsigned u32x4 __attribute__((ext_vector_type(4)));
typedef unsigned u32x2 __attribute__((ext_vector_type(2)));
typedef __bf16 bf2_t __attribute__((ext_vector_type(2)));

constexpr int DM = 2048, DEPTH = 4, T_P = 32768, T_S = 8192, T = T_P + T_S;
constexpr int INC = 2368, INCP = 2560, QL = 512, KVL = 256, NQ = 1536, NKV = 2048, DFF = 5632, DFF2 = 11264;
constexpr int CHUNK = 10240, NCHUNK = 4;
constexpr float ALPHA = 1.681792830507429f;
constexpr float LOG2E = 1.4426950408889634f;
constexpr int LDS_BYTES = 131072;

constexpr size_t WS_WIN = 0;
constexpr size_t WS_WUQ = WS_WIN + (size_t)DEPTH * INCP * DM * 2;
constexpr size_t WS_WUKV = WS_WUQ + (size_t)DEPTH * NQ * QL * 2;
constexpr size_t WS_WO = WS_WUKV + (size_t)DEPTH * NKV * KVL * 2;
constexpr size_t WS_WUP = WS_WO + (size_t)DEPTH * DM * DM * 2;
constexpr size_t WS_WDN = WS_WUP + (size_t)DEPTH * DFF2 * DM * 2;
constexpr size_t WS_XB = WS_WDN + (size_t)DEPTH * DM * DFF * 2;
constexpr size_t WS_KR = WS_XB + (size_t)T * DM * 2;
constexpr size_t WS_RINV = WS_KR + (size_t)T * 64 * 2;
constexpr size_t WS_ROPE = WS_RINV + (size_t)T * 2 * 4;
constexpr size_t WS_BIAS = WS_ROPE + (size_t)8192 * 64 * 4;
constexpr size_t WS_BIG = WS_BIAS + 8448;
constexpr size_t WS_H = WS_BIG;
constexpr size_t WS_QB = WS_H + (size_t)T * INC * 2;
constexpr size_t WS_KVB = WS_QB + (size_t)T * NQ * 2;
constexpr size_t WS_ATT = WS_KVB + (size_t)T * NKV * 2;
constexpr size_t WS_GATED = WS_BIG;
constexpr size_t WS_UCH = WS_GATED + (size_t)T * DFF * 2;
constexpr size_t WS_END = WS_UCH + (size_t)CHUNK * DFF2 * 2;
static_assert(WS_ATT + (size_t)T * DM * 2 <= WS_END, "alias region");

DI float bf2f(unsigned short b) { return __uint_as_float(((unsigned)b) << 16); }
DI unsigned pk2(float a, float b) { bf2_t v; v[0] = (__bf16)a; v[1] = (__bf16)b; return __builtin_bit_cast(unsigned, v); }
DI unsigned short f2bf(float a) { return (unsigned short)(pk2(a, 0.f) & 0xffffu); }
DI float wave_sum(float v) {
#pragma unroll
    for (int o = 32; o >= 1; o >>= 1) v += __shfl_xor(v, o);
    return v;
}

namespace pg8 {
constexpr int BM = 256, BK = 64, HALF = 128, HTB = HALF * BK * 2, STAGE_BYTES = 8 * HTB, NXCD = 8, WGM = 8;
DI int lds_byte(int r, int c) { const int st = (r >> 4) * 2 + (c >> 5), rr = r & 15, cc = c & 31, ob = rr * 64 + cc * 2; return st * 1024 + (ob ^ (((ob >> 9) & 1) << 5)); }
DI void stage_rc(int b, int& R, int& C) { const int st = b / 1024, sb = b % 1024, swz = sb ^ (((sb >> 9) & 1) << 5); R = (st >> 1) * 16 + swz / 64; C = (st & 1) * 32 + (swz % 64) / 2; }
DI int perm32(int rho) { const int n = rho >> 4, i = rho & 15; return 8 * (i >> 2) + 4 * n + (i & 3); }
struct Unit { int pm, pn; };
struct Gemm { const bf16_t* A; const bf16_t* Bt; int M, N, K, lda; };
struct StaticOrder {
    int nM, nN, nwg, G, c;
    DI void init(int M, int N, int G_, int c_) { nM = M / BM; nN = N / BM; nwg = nM * nN; G = G_; c = c_; }
    DI bool next(int i, Unit& u) const {
        const long L = (long)i * G + c; if (L >= nwg) return false;
        int wgid = (int)L; { const int q = nwg / NXCD, r = nwg % NXCD, xcd = wgid % NXCD, off = wgid / NXCD; wgid = (xcd < r ? xcd * (q + 1) : r * (q + 1) + (xcd - r) * q) + off; }
        const int nig = WGM * nN, gid = wgid / nig, fm = gid * WGM, gsz = (nM - fm) < WGM ? (nM - fm) : WGM;
        u.pm = fm + ((wgid % nig) % gsz); u.pn = (wgid % nig) / gsz; return true;
    }
};
struct EpiBf16 {
    static constexpr bool PERM = true;
    bf16_t* O; int ldc; int ncols; const float* rscale;
    DI void operator()(const f32x4 (&acc)[2][2][4][2], const Unit& u, int wr, int wc, int fr, int fq) const {
        const int row0 = u.pm * BM + wr * 64 + fr, col0 = u.pn * BM + wc * 32 + 8 * fq;
#pragma unroll
        for (int ai = 0; ai < 2; ++ai)
#pragma unroll
            for (int m = 0; m < 4; ++m) {
                const int row = row0 + ai * HALF + m * 16;
                const float rs = rscale ? rscale[(size_t)row * 2] : 1.0f;
                bf16_t* rowp = O + (size_t)row * ldc + col0;
#pragma unroll
                for (int bj = 0; bj < 2; ++bj) {
                    if (col0 + bj * HALF < ncols) {
                        const f32x4 v0 = acc[ai][bj][m][0] * rs, v1 = acc[ai][bj][m][1] * rs;
                        u32x4 w; w.x = pk2(v0[0], v0[1]); w.y = pk2(v0[2], v0[3]); w.z = pk2(v1[0], v1[1]); w.w = pk2(v1[2], v1[3]);
                        *(u32x4*)(rowp + bj * HALF) = w;
                    }
                }
            }
    }
};
struct EpiResid {
    static constexpr bool PERM = false;
    float* X;
    DI void operator()(const f32x4 (&acc)[2][2][4][2], const Unit& u, int wr, int wc, int fr, int fq) const {
        const int row0 = u.pm * BM + wr * 64 + fr, col0 = u.pn * BM + wc * 32 + 4 * fq;
#pragma unroll
        for (int ai = 0; ai < 2; ++ai)
#pragma unroll
            for (int m = 0; m < 4; ++m) {
                float* rowp = X + (size_t)(row0 + ai * HALF + m * 16) * DM + col0;
#pragma unroll
                for (int bj = 0; bj < 2; ++bj)
#pragma unroll
                    for (int n = 0; n < 2; ++n) {
                        float* p = rowp + bj * HALF + n * 16;
                        f32x4 x = *(const f32x4*)p;
                        x = x * ALPHA + acc[ai][bj][m][n];
                        *(f32x4*)p = x;
                    }
            }
    }
};

template <class Epi>
DI void gemm_phase(LAS unsigned char* lds, const Gemm g, const StaticOrder& S, const Epi& E) {
    int tid_ = threadIdx.x; asm volatile("" : "+v"(tid_));
    int K_ = g.K, lda_ = g.lda; asm volatile("" : "+s"(K_), "+s"(lda_));
    const int tid = tid_, wid = __builtin_amdgcn_readfirstlane(tid >> 6), lane = tid & 63, wr = wid >> 2, wc = wid & 3, fr = lane & 15, fq = lane >> 4;
    const int K = K_, nt = K / BK, lda = lda_;
    unsigned voffA[2], voffB[2];
#pragma unroll
    for (int i = 0; i < 2; ++i) { int R, C; stage_rc(tid * 16 + i * 8192, R, C); const int Rb = Epi::PERM ? ((R & ~31) + perm32(R & 31)) : R;
        voffA[i] = (unsigned)(R * lda + C) * 2u; voffB[i] = (unsigned)(Rb * K + C) * 2u; }
    const size_t kstep = (size_t)(BK * 2);
    const size_t hstepA = (size_t)HALF * lda * 2, hstepB = (size_t)HALF * K * 2;
    const size_t tstepA = 2 * hstepA, tstepB = 2 * hstepB;
    const unsigned ldsw = (unsigned)wid * 1024u;
    const int aoff = lds_byte(wr * 64 + fr, fq * 8), boff = lds_byte(wc * 32 + fr, fq * 8);
#define PG8_SA(b, h) (((b) * 2 + (h)) * HTB)
#define PG8_SB(b, h) ((4 + (b) * 2 + (h)) * HTB)
#define PG8_STAGE(bufoff, gbase, voff) do { _Pragma("unroll") for (int _i = 0; _i < 2; ++_i) \
        __builtin_amdgcn_global_load_lds((const unsigned*)((const char*)(gbase) + (voff)[_i]), (LAS unsigned*)(lds + (bufoff) + ldsw + _i * 8192), 16, 0, 0); } while (0)
#define PG8_LDA(dst, b, h) do { _Pragma("unroll") for (int m = 0; m < 4; ++m) _Pragma("unroll") for (int k = 0; k < 2; ++k) dst[m][k] = *(const LAS bf16x8*)(lds + PG8_SA(b, h) + aoff + m * 2048 + k * 1024); } while (0)
#define PG8_LDB(dst, b, h) do { _Pragma("unroll") for (int n = 0; n < 2; ++n) _Pragma("unroll") for (int k = 0; k < 2; ++k) dst[n][k] = *(const LAS bf16x8*)(lds + PG8_SB(b, h) + boff + n * 2048 + k * 1024); } while (0)
#define PG8_MMA(ai, bj, At, Bt) do { __builtin_amdgcn_s_setprio(1); _Pragma("unroll") for (int m = 0; m < 4; ++m) _Pragma("unroll") for (int n = 0; n < 2; ++n) _Pragma("unroll") for (int k = 0; k < 2; ++k) \
        acc[ai][bj][m][n] = __builtin_amdgcn_mfma_f32_16x16x32_bf16(Bt[n][k], At[m][k], acc[ai][bj][m][n], 0, 0, 0); __builtin_amdgcn_s_setprio(0); } while (0)
#define PG8_WAIT_V(n) asm volatile("s_waitcnt vmcnt(" #n ")" ::: "memory")
#define PG8_WAIT_L(n) asm volatile("s_waitcnt lgkmcnt(" #n ")" ::: "memory")
#define PG8_BAR __builtin_amdgcn_s_barrier()
#define PG8_SCHED __builtin_amdgcn_sched_barrier(0)
    Unit cur, nxt; int ui = 0;
    if (!S.next(0, cur)) return;
    f32x4 acc[2][2][4][2];
#pragma unroll
    for (int a = 0; a < 2; ++a)
#pragma unroll
        for (int b = 0; b < 2; ++b)
#pragma unroll
            for (int m = 0; m < 4; ++m)
#pragma unroll
                for (int n = 0; n < 2; ++n) acc[a][b][m][n] = (f32x4){0.f, 0.f, 0.f, 0.f};
    bf16x8 At[4][2], B0[2][2], B1[2][2];
    const char* cA = (const char*)g.A + (size_t)cur.pm * tstepA; const char* cB = (const char*)g.Bt + (size_t)cur.pn * tstepB;
    PG8_STAGE(PG8_SB(0, 0), cB, voffB); PG8_STAGE(PG8_SA(0, 0), cA, voffA); PG8_STAGE(PG8_SB(0, 1), cB + hstepB, voffB); PG8_STAGE(PG8_SA(0, 1), cA + hstepA, voffA);
    if (wr == 1) PG8_BAR;
    PG8_WAIT_V(4); PG8_BAR;
    PG8_STAGE(PG8_SB(1, 0), cB + kstep, voffB); PG8_STAGE(PG8_SA(1, 0), cA + kstep, voffA); PG8_STAGE(PG8_SB(1, 1), cB + hstepB + kstep, voffB);
    PG8_WAIT_V(6); PG8_BAR;
    for (;;) {
        const bool has_next = S.next(ui + 1, nxt);
        const char* nA = has_next ? (const char*)g.A + (size_t)nxt.pm * tstepA : cA; const char* nB = has_next ? (const char*)g.Bt + (size_t)nxt.pn * tstepB : cB;
        for (int t = 0; t < nt; t += 2) {
            const bool last = (t == nt - 2);
            const char* a1 = cA + (size_t)(t + 1) * kstep;
            const char* a2 = last ? nA : cA + (size_t)(t + 2) * kstep; const char* b2 = last ? nB : cB + (size_t)(t + 2) * kstep;
            const char* a3 = a2 + kstep; const char* b3 = b2 + kstep;
            PG8_LDB(B0, 0, 0); PG8_SCHED; PG8_LDA(At, 0, 0); PG8_STAGE(PG8_SA(1, 1), a1 + hstepA, voffA);
            PG8_WAIT_L(8); PG8_BAR; PG8_WAIT_L(0); PG8_MMA(0, 0, At, B0); PG8_BAR; PG8_SCHED;
            PG8_LDB(B1, 0, 1); PG8_STAGE(PG8_SB(0, 0), b2, voffB);
            PG8_BAR; PG8_WAIT_L(0); PG8_MMA(0, 1, At, B1); PG8_BAR;
            PG8_LDA(At, 0, 1); PG8_STAGE(PG8_SA(0, 0), a2, voffA);
            PG8_BAR; PG8_WAIT_L(0); PG8_MMA(1, 0, At, B0); PG8_BAR; PG8_SCHED;
            PG8_STAGE(PG8_SB(0, 1), b2 + hstepB, voffB);
            PG8_WAIT_V(6); PG8_BAR; PG8_MMA(1, 1, At, B1); PG8_BAR;
            PG8_LDB(B0, 1, 0); PG8_SCHED; PG8_LDA(At, 1, 0); PG8_STAGE(PG8_SA(0, 1), a2 + hstepA, voffA);
            PG8_WAIT_L(8); PG8_BAR; PG8_WAIT_L(0); PG8_MMA(0, 0, At, B0); PG8_BAR; PG8_SCHED;
            PG8_LDB(B1, 1, 1); PG8_STAGE(PG8_SB(1, 0), b3, voffB);
            PG8_BAR; PG8_WAIT_L(0); PG8_MMA(0, 1, At, B1); PG8_BAR;
            PG8_LDA(At, 1, 1); PG8_STAGE(PG8_SA(1, 0), a3, voffA);
            PG8_BAR; PG8_WAIT_L(0); PG8_MMA(1, 0, At, B0); PG8_BAR; PG8_SCHED;
            PG8_STAGE(PG8_SB(1, 1), b3 + hstepB, voffB);
            PG8_WAIT_V(6); PG8_BAR; PG8_MMA(1, 1, At, B1); PG8_BAR;
        }
        E(acc, cur, wr, wc, fr, fq);
        if (!has_next) break;
#pragma unroll
        for (int a = 0; a < 2; ++a)
#pragma unroll
            for (int b = 0; b < 2; ++b)
#pragma unroll
                for (int m = 0; m < 4; ++m)
#pragma unroll
                    for (int n = 0; n < 2; ++n) acc[a][b][m][n] = (f32x4){0.f, 0.f, 0.f, 0.f};
        cur = nxt; cA = nA; cB = nB; ++ui;
    }
    PG8_WAIT_V(0);
    if (wr == 0) PG8_BAR;
    PG8_BAR;
#undef PG8_SA
#undef PG8_SB
#undef PG8_STAGE
#undef PG8_LDA
#undef PG8_LDB
#undef PG8_MMA
#undef PG8_WAIT_V
#undef PG8_WAIT_L
#undef PG8_BAR
#undef PG8_SCHED
}
}

struct Params {
    const float* x_prompt; const float* x_sample; const float* rel_bias; const float* w_in; const float* sink; const float* q_norm_g;
    const float* w_uq; const float* kv_norm_g; const float* w_ukv; const float* w_o; const float* ln1_g; const float* ln1_b;
    const float* w_up; const float* conv_w; const float* conv_b; const float* w_down; const float* ln2_g; const float* ln2_b;
    float* out; unsigned char* ws;
};

DI void tconv(LAS float* tile, const float* __restrict__ src, int K, int N, int Npad, bf16_t* __restrict__ dst, const float* __restrict__ ks, int bid, int nblk) {
    const int tid = threadIdx.x;
    const int nkt = K >> 6, nnt = Npad >> 6, ntl = nkt * nnt;
    for (int tl = bid; tl < ntl; tl += nblk) {
        const int kt = tl % nkt, ntile = tl / nkt;
        const int k0 = kt << 6, n0 = ntile << 6;
        if (n0 < N) {
#pragma unroll
            for (int i = 0; i < 8; ++i) {
                const int k = i * 8 + (tid >> 6), n = tid & 63;
                float v = src[(size_t)(k0 + k) * N + n0 + n];
                if (ks) v *= ks[k0 + k];
                tile[k * 65 + n] = v;
            }
        }
        __syncthreads();
        {
            const int n = tid >> 3, kc = tid & 7;
            u32x4 w = (u32x4){0u, 0u, 0u, 0u};
            if (n0 < N) {
                const LAS float* tp = tile + (kc * 8) * 65 + n;
                w.x = pk2(tp[0 * 65], tp[1 * 65]); w.y = pk2(tp[2 * 65], tp[3 * 65]); w.z = pk2(tp[4 * 65], tp[5 * 65]); w.w = pk2(tp[6 * 65], tp[7 * 65]);
            }
            *(u32x4*)(dst + (size_t)(n0 + n) * K + k0 + kc * 8) = w;
        }
        __syncthreads();
    }
}

DI int t5_bucket(int rel) {
    const int n = rel < 0 ? -rel : rel;
    int b;
    if (n < 8) b = n;
    else { const int j = 31 - __clz((n * n) >> 6); b = 8 + j; if (b > 15) b = 15; }
    return b + (rel > 0 ? 16 : 0);
}

DI void prologue(const Params& p, LAS unsigned char* lds) {
    const int bid = blockIdx.x, nblk = gridDim.x, tid = threadIdx.x;
    LAS float* tile = (LAS float*)lds;
    unsigned char* ws = p.ws;
    int rot = 0;
    for (int l = 0; l < DEPTH; ++l) {
        tconv(tile, p.w_in + (size_t)l * DM * INC, DM, INC, INCP, (bf16_t*)(ws + WS_WIN) + (size_t)l * INCP * DM, nullptr, (bid + rot) % nblk, nblk); rot += 61;
        tconv(tile, p.w_uq + (size_t)l * QL * NQ, QL, NQ, NQ, (bf16_t*)(ws + WS_WUQ) + (size_t)l * NQ * QL, p.q_norm_g + l * QL, (bid + rot) % nblk, nblk); rot += 61;
        tconv(tile, p.w_ukv + (size_t)l * KVL * NKV, KVL, NKV, NKV, (bf16_t*)(ws + WS_WUKV) + (size_t)l * NKV * KVL, p.kv_norm_g + l * KVL, (bid + rot) % nblk, nblk); rot += 61;
        tconv(tile, p.w_o + (size_t)l * DM * DM, DM, DM, DM, (bf16_t*)(ws + WS_WO) + (size_t)l * DM * DM, nullptr, (bid + rot) % nblk, nblk); rot += 61;
        tconv(tile, p.w_up + (size_t)l * DM * DFF2, DM, DFF2, DFF2, (bf16_t*)(ws + WS_WUP) + (size_t)l * DFF2 * DM, nullptr, (bid + rot) % nblk, nblk); rot += 61;
        tconv(tile, p.w_down + (size_t)l * DFF * DM, DFF, DM, DM, (bf16_t*)(ws + WS_WDN) + (size_t)l * DM * DFF, nullptr, (bid + rot) % nblk, nblk); rot += 61;
    }
    {
        const size_t n4 = (size_t)T * DM / 4, np4 = (size_t)T_P * DM / 4;
        bf16_t* xb = (bf16_t*)(ws + WS_XB);
        for (size_t i = (size_t)bid * 512 + tid; i < n4; i += (size_t)nblk * 512) {
            const f32x4 v = (i < np4) ? ((const f32x4*)p.x_prompt)[i] : ((const f32x4*)p.x_sample)[i - np4];
            ((f32x4*)p.out)[i] = v;
            u32x2 w; w.x = pk2(v[0], v[1]); w.y = pk2(v[2], v[3]);
            ((u32x2*)xb)[i] = w;
        }
    }
    {
        float* rt = (float*)(ws + WS_ROPE);
        for (int idx = bid * 512 + tid; idx < 8192 * 32; idx += nblk * 512) {
            const int pos = idx >> 5, i = idx & 31;
            double inv = 1.0;
            for (int j = 0; j < i; ++j) inv *= 0.7498942093324558;
            const float ang = (float)pos * (float)inv;
            const double a = (double)ang;
            const double kk = __builtin_rint(a * 0.15915494309189535);
            const double r = a - kk * 6.283185307179586;
            const double r2 = r * r;
            double ts = r, ss = r, tc = 1.0, sc = 1.0;
#pragma unroll
            for (int k = 1; k <= 14; ++k) {
                ts *= -r2 / (double)((2 * k) * (2 * k + 1)); ss += ts;
                tc *= -r2 / (double)((2 * k - 1) * (2 * k)); sc += tc;
            }
            rt[pos * 64 + i] = (float)sc; rt[pos * 64 + 32 + i] = (float)ss;
        }
    }
    if (bid == 0) {
        float* bt = (float*)(ws + WS_BIAS);
        for (int idx = tid; idx < 8 * 257; idx += 512) {
            const int head = idx / 257, rel = idx % 257 - 128;
            bt[idx] = p.rel_bias[t5_bucket(rel) * 8 + head] * LOG2E;
        }
    }
}

DI void ln_phase(float* X, bf16_t* XB, const float* __restrict__ g, const float* __restrict__ b) {
    int tid_ = threadIdx.x; asm volatile("" : "+v"(tid_));
    const int lane = tid_ & 63, gw = blockIdx.x * 8 + (tid_ >> 6), nw = gridDim.x * 8;
    for (int row = gw; row < T; row += nw) {
        float* xr = X + (size_t)row * DM;
        f32x4 v[8];
#pragma unroll
        for (int i = 0; i < 8; ++i) v[i] = *(const f32x4*)(xr + (i * 64 + lane) * 4);
        float s = 0.f;
#pragma unroll
        for (int i = 0; i < 8; ++i) s += (v[i][0] + v[i][1]) + (v[i][2] + v[i][3]);
        const float mean = wave_sum(s) * (1.0f / DM);
        float q = 0.f;
#pragma unroll
        for (int i = 0; i < 8; ++i) { v[i] = v[i] - mean; q += (v[i][0] * v[i][0] + v[i][1] * v[i][1]) + (v[i][2] * v[i][2] + v[i][3] * v[i][3]); }
        const float rstd = rsqrtf(wave_sum(q) * (1.0f / DM) + 1e-5f);
        bf16_t* br = XB + (size_t)row * DM;
#pragma unroll
        for (int i = 0; i < 8; ++i) {
            const int c = (i * 64 + lane) * 4;
            const f32x4 gg = *(const f32x4*)(g + c), bb = *(const f32x4*)(b + c);
            const f32x4 y = v[i] * rstd * gg + bb;
            *(f32x4*)(xr + c) = y;
            u32x2 w; w.x = pk2(y[0], y[1]); w.y = pk2(y[2], y[3]);
            *(u32x2*)(br + c) = w;
        }
    }
}

DI void prep_phase(const bf16_t* __restrict__ H, float* __restrict__ RINV, bf16_t* __restrict__ KR, const float* __restrict__ rope) {
    int tid_ = threadIdx.x; asm volatile("" : "+v"(tid_));
    const int lane = tid_ & 63, gw = blockIdx.x * 8 + (tid_ >> 6), nw = gridDim.x * 8;
    for (int tok = gw; tok < T; tok += nw) {
        const bf16_t* hr = H + (size_t)tok * INC;
        const u32x4 cq = *(const u32x4*)(hr + 1536 + lane * 8);
        const u32x2 ck = *(const u32x2*)(hr + 2048 + lane * 4);
        const float xr = bf2f(hr[2304 + lane]);
        float sq = 0.f, sk = 0.f;
#pragma unroll
        for (int j = 0; j < 4; ++j) { const float a = __uint_as_float(cq[j] << 16), c = __uint_as_float(cq[j] & 0xffff0000u); sq += a * a + c * c; }
#pragma unroll
        for (int j = 0; j < 2; ++j) { const float a = __uint_as_float(ck[j] << 16), c = __uint_as_float(ck[j] & 0xffff0000u); sk += a * a + c * c; }
        sq = wave_sum(sq); sk = wave_sum(sk);
        if (lane == 0) { RINV[(size_t)tok * 2] = rsqrtf(sq * (1.0f / QL) + 1e-6f); RINV[(size_t)tok * 2 + 1] = rsqrtf(sk * (1.0f / KVL) + 1e-6f); }
        const int pos = tok < T_P ? (tok & 2047) : tok - T_P;
        const float other = __shfl_xor(xr, 32);
        const int i = lane & 31;
        const float c = rope[pos * 64 + i], s = rope[pos * 64 + 32 + i];
        const float o = lane < 32 ? xr * c - other * s : xr * c + other * s;
        KR[(size_t)tok * 64 + lane] = f2bf(o);
    }
}

DI void convglu_phase(const bf16_t* __restrict__ U, bf16_t* __restrict__ Gd, int tok_base, const float* __restrict__ cw, const float* __restrict__ cb) {
    constexpr int NCG = DFF / 8, R = 8, NTG = CHUNK / R;
    const int nth = gridDim.x * 512;
    int tid_ = threadIdx.x; asm volatile("" : "+v"(tid_));
    for (int it = blockIdx.x * 512 + tid_; it < NCG * NTG; it += nth) {
        const int cg8 = it % NCG, tg = it / NCG;
        const int c0 = cg8 * 8, tl0 = tg * R;
        const int tok = tok_base + tl0;
        const int pos0 = tok < T_P ? (tok & 2047) : tok - T_P;
        const int S = tok < T_P ? 2048 : 8192;
        float wg[3][8], wv[3][8], bg[8], bv[8];
#pragma unroll
        for (int k = 0; k < 3; ++k)
#pragma unroll
            for (int j = 0; j < 8; ++j) { wg[k][j] = cw[k * DFF2 + c0 + j]; wv[k][j] = cw[k * DFF2 + DFF + c0 + j]; }
#pragma unroll
        for (int j = 0; j < 8; ++j) { bg[j] = cb[c0 + j]; bv[j] = cb[DFF + c0 + j]; }
        u32x4 pg = (u32x4){0u, 0u, 0u, 0u}, pv = pg, cgv, cvv, ng, nv;
        const bf16_t* up = U + (size_t)tl0 * DFF2 + c0;
        if (pos0 > 0) { pg = *(const u32x4*)(up - DFF2); pv = *(const u32x4*)(up - DFF2 + DFF); }
        cgv = *(const u32x4*)(up); cvv = *(const u32x4*)(up + DFF);
#pragma unroll
        for (int r = 0; r < R; ++r) {
            if (pos0 + r + 1 < S) { ng = *(const u32x4*)(up + (size_t)(r + 1) * DFF2); nv = *(const u32x4*)(up + (size_t)(r + 1) * DFF2 + DFF); }
            else { ng = (u32x4){0u, 0u, 0u, 0u}; nv = ng; }
            float o[8];
#pragma unroll
            for (int j = 0; j < 8; ++j) {
                const int w = j >> 1; const bool hi = j & 1;
                const float a0 = hi ? __uint_as_float(pg[w] & 0xffff0000u) : __uint_as_float(pg[w] << 16);
                const float a1 = hi ? __uint_as_float(cgv[w] & 0xffff0000u) : __uint_as_float(cgv[w] << 16);
                const float a2 = hi ? __uint_as_float(ng[w] & 0xffff0000u) : __uint_as_float(ng[w] << 16);
                const float b0 = hi ? __uint_as_float(pv[w] & 0xffff0000u) : __uint_as_float(pv[w] << 16);
                const float b1 = hi ? __uint_as_float(cvv[w] & 0xffff0000u) : __uint_as_float(cvv[w] << 16);
                const float b2 = hi ? __uint_as_float(nv[w] & 0xffff0000u) : __uint_as_float(nv[w] << 16);
                const float gt = a0 * wg[0][j] + a1 * wg[1][j] + a2 * wg[2][j] + bg[j];
                const float vl = b0 * wv[0][j] + b1 * wv[1][j] + b2 * wv[2][j] + bv[j];
                o[j] = gt * __frcp_rn(1.0f + __expf(-gt)) * vl;
            }
            u32x4 w4; w4.x = pk2(o[0], o[1]); w4.y = pk2(o[2], o[3]); w4.z = pk2(o[4], o[5]); w4.w = pk2(o[6], o[7]);
            *(u32x4*)(Gd + (size_t)(tok + r) * DFF + c0) = w4;
            pg = cgv; pv = cvv; cgv = ng; cvv = nv;
        }
    }
}

#define MFMA32(a, b, c) __builtin_amdgcn_mfma_f32_32x32x16_bf16((a), (b), (c), 0, 0, 0)
constexpr int ATT_VB0 = 51200, ATT_VST = 320, ATT_VBSZ = 64 * ATT_VST, ATT_BIAS_OFF = 92160;

template <bool WIN>
DI void attn_item(LAS unsigned char* lds, const bf16_t* __restrict__ Qrow, const bf16_t* __restrict__ Kg, int ldk, const bf16_t* __restrict__ KRg,
                  const bf16_t* __restrict__ Vg, int ldv, bf16_t* __restrict__ Orow, const float* __restrict__ ropeq, const LAS float* biasl, float sink2,
                  int tok0, int S, int qpos, int kt_first, int ntiles) {
    constexpr int DQK = WIN ? 128 : 192, NKS = DQK / 16, CPK = DQK / 8, KST = DQK * 2 + 16, KBSZ = 64 * KST, KCH = (64 * CPK) / 512;
    int tid_ = threadIdx.x; asm volatile("" : "+v"(tid_));
    const int tid = tid_, lane = tid & 63, lq = lane & 31, h = lane >> 5;
    const float c2 = WIN ? 0.12751743082459868f : 0.10411754627697264f;
    bf16x8 qf[NKS];
#pragma unroll
    for (int ks = 0; ks < NKS; ++ks) qf[ks] = *(const bf16x8*)(Qrow + 16 * ks + 8 * h);
    if (!WIN) {
#pragma unroll
        for (int kk = 0; kk < 2; ++kk) {
            const int i0 = 16 * kk + 8 * h;
            const f32x4 ca = *(const f32x4*)(ropeq + i0), cb = *(const f32x4*)(ropeq + i0 + 4);
            const f32x4 sa = *(const f32x4*)(ropeq + 32 + i0), sb = *(const f32x4*)(ropeq + 32 + i0 + 4);
            bf16x8 x1 = qf[8 + kk], x2 = qf[10 + kk];
#pragma unroll
            for (int j = 0; j < 8; ++j) {
                const float c = j < 4 ? ca[j & 3] : cb[j & 3], s = j < 4 ? sa[j & 3] : sb[j & 3];
                const float a = bf2f((unsigned short)x1[j]), b = bf2f((unsigned short)x2[j]);
                x1[j] = (short)f2bf(a * c - b * s); x2[j] = (short)f2bf(b * c + a * s);
            }
            qf[8 + kk] = x1; qf[10 + kk] = x2;
        }
    }
    f32x16 o[4];
#pragma unroll
    for (int c = 0; c < 4; ++c)
#pragma unroll
        for (int r = 0; r < 16; ++r) o[c][r] = 0.f;
    float m = WIN ? sink2 : -1e30f;
    float l = (WIN && h == 0) ? 1.0f : 0.0f;
    u32x4 kreg[KCH], vreg[2];
#define ATT_LOAD(kt0_) do { \
        _Pragma("unroll") for (int i_ = 0; i_ < KCH; ++i_) { const int ch_ = tid + 512 * i_; const int key_ = ch_ / CPK, cc_ = ch_ - key_ * CPK; \
            int kp_ = (kt0_) + key_; kp_ = kp_ < 0 ? 0 : (kp_ > S - 1 ? S - 1 : kp_); const size_t tk_ = (size_t)(tok0 + kp_); \
            const bf16_t* src_ = (WIN || cc_ < 16) ? (Kg + tk_ * ldk + cc_ * 8) : (KRg + tk_ * 64 + (cc_ - 16) * 8); kreg[i_] = *(const u32x4*)src_; } \
        _Pragma("unroll") for (int i_ = 0; i_ < 2; ++i_) { const int ch_ = tid + 512 * i_; const int key_ = ch_ >> 4, cc_ = ch_ & 15; \
            int kp_ = (kt0_) + key_; kp_ = kp_ < 0 ? 0 : (kp_ > S - 1 ? S - 1 : kp_); const size_t tk_ = (size_t)(tok0 + kp_); \
            vreg[i_] = *(const u32x4*)(Vg + tk_ * ldv + cc_ * 8); } } while (0)
#define ATT_STORE(buf_) do { \
        _Pragma("unroll") for (int i_ = 0; i_ < KCH; ++i_) { const int ch_ = tid + 512 * i_; const int key_ = ch_ / CPK, cc_ = ch_ - key_ * CPK; \
            *(LAS u32x4*)(lds + (buf_) * KBSZ + key_ * KST + cc_ * 16) = kreg[i_]; } \
        _Pragma("unroll") for (int i_ = 0; i_ < 2; ++i_) { const int ch_ = tid + 512 * i_; const int key_ = ch_ >> 4, cc_ = ch_ & 15; \
            *(LAS u32x4*)(lds + ATT_VB0 + (buf_) * ATT_VBSZ + key_ * ATT_VST + cc_ * 16) = vreg[i_]; } } while (0)
    ATT_LOAD(kt_first); ATT_STORE(0);
    __syncthreads();
    for (int t = 0; t < ntiles; ++t) {
        const int buf = t & 1;
        const bool more = (t + 1 < ntiles);
        if (more) ATT_LOAD(kt_first + 64 * (t + 1));
        const LAS unsigned char* kb_ = lds + buf * KBSZ + lq * KST + h * 16;
        f32x16 st[2];
#pragma unroll
        for (int kb = 0; kb < 2; ++kb) {
#pragma unroll
            for (int r = 0; r < 16; ++r) st[kb][r] = 0.f;
#pragma unroll
            for (int ks = 0; ks < NKS; ++ks) {
                const bf16x8 a = *(const LAS bf16x8*)(kb_ + kb * 32 * KST + ks * 32);
                st[kb] = MFMA32(a, qf[ks], st[kb]);
            }
        }
        float mx = -INFINITY;
        if (WIN) {
            const int kt0 = kt_first + 64 * t;
#pragma unroll
            for (int kb = 0; kb < 2; ++kb)
#pragma unroll
                for (int r = 0; r < 16; ++r) {
                    const int key = kt0 + kb * 32 + (r & 3) + 8 * (r >> 2) + 4 * h;
                    const int rel = key - qpos;
                    const bool ok = (rel >= -128) && (rel <= 128) && (key >= 0) && (key < S);
                    const int relc = rel < -128 ? -128 : (rel > 128 ? 128 : rel);
                    const float tt = st[kb][r] * c2 + biasl[relc];
                    st[kb][r] = ok ? tt : -INFINITY;
                }
        }
#pragma unroll
        for (int kb = 0; kb < 2; ++kb)
#pragma unroll
            for (int r = 0; r < 16; ++r) mx = fmaxf(mx, st[kb][r]);
        mx = fmaxf(mx, __shfl_xor(mx, 32));
        const float m_new = fmaxf(m, mx);
        float alpha, rs = 0.f;
        if (WIN) {
            alpha = __builtin_amdgcn_exp2f(m - m_new);
#pragma unroll
            for (int kb = 0; kb < 2; ++kb)
#pragma unroll
                for (int r = 0; r < 16; ++r) { const float pp = __builtin_amdgcn_exp2f(st[kb][r] - m_new); st[kb][r] = pp; rs += pp; }
        } else {
            alpha = __builtin_amdgcn_exp2f((m - m_new) * c2);
            const float mc = m_new * c2;
#pragma unroll
            for (int kb = 0; kb < 2; ++kb)
#pragma unroll
                for (int r = 0; r < 16; ++r) { const float pp = __builtin_amdgcn_exp2f(st[kb][r] * c2 - mc); st[kb][r] = pp; rs += pp; }
        }
        l = l * alpha + rs; m = m_new;
#pragma unroll
        for (int c = 0; c < 4; ++c)
#pragma unroll
            for (int r = 0; r < 16; ++r) o[c][r] *= alpha;
        const LAS unsigned char* vl_ = lds + ATT_VB0 + buf * ATT_VBSZ + (4 * h + ((lane & 15) >> 2)) * ATT_VST + ((lane >> 4) & 1) * 32 + (lane & 3) * 8;
#pragma unroll
        for (int kb = 0; kb < 2; ++kb)
#pragma unroll
            for (int s = 0; s < 2; ++s) {
                u32x4 pw;
                pw.x = pk2(st[kb][8 * s + 0], st[kb][8 * s + 1]); pw.y = pk2(st[kb][8 * s + 2], st[kb][8 * s + 3]);
                pw.z = pk2(st[kb][8 * s + 4], st[kb][8 * s + 5]); pw.w = pk2(st[kb][8 * s + 6], st[kb][8 * s + 7]);
                const bf16x8 pf = __builtin_bit_cast(bf16x8, pw);
#pragma unroll
                for (int c = 0; c < 4; ++c) {
                    const s16x4 lo = __builtin_amdgcn_ds_read_tr16_b64_v4i16((LAS s16x4*)(vl_ + (kb * 32 + 16 * s) * ATT_VST + c * 64));
                    const s16x4 hi = __builtin_amdgcn_ds_read_tr16_b64_v4i16((LAS s16x4*)(vl_ + (kb * 32 + 16 * s + 8) * ATT_VST + c * 64));
                    const bf16x8 a = __builtin_shufflevector(lo, hi, 0, 1, 2, 3, 4, 5, 6, 7);
                    o[c] = MFMA32(a, pf, o[c]);
                }
            }
        if (more) ATT_STORE(buf ^ 1);
        __syncthreads();
    }
#undef ATT_LOAD
#undef ATT_STORE
    const float lt = l + __shfl_xor(l, 32);
    const float inv = 1.0f / lt;
#pragma unroll
    for (int c = 0; c < 4; ++c)
#pragma unroll
        for (int rg = 0; rg < 4; ++rg) {
            u32x2 w; w.x = pk2(o[c][4 * rg] * inv, o[c][4 * rg + 1] * inv); w.y = pk2(o[c][4 * rg + 2] * inv, o[c][4 * rg + 3] * inv);
            *(u32x2*)(Orow + 32 * c + 8 * rg + 4 * h) = w;
        }
}

DI void attn_phase(const Params& p, LAS unsigned char* lds, int layer) {
    unsigned char* ws = p.ws;
    const bf16_t* H = (const bf16_t*)(ws + WS_H); const bf16_t* QB = (const bf16_t*)(ws + WS_QB); const bf16_t* KVB = (const bf16_t*)(ws + WS_KVB);
    const bf16_t* KR = (const bf16_t*)(ws + WS_KR); bf16_t* ATT = (bf16_t*)(ws + WS_ATT);
    const float* rope = (const float*)(ws + WS_ROPE); const float* bt = (const float*)(ws + WS_BIAS);
    int tid_ = threadIdx.x; asm volatile("" : "+v"(tid_));
    const int tid = tid_, wid = tid >> 6, lane = tid & 63, lq = lane & 31;
    LAS float* biasl = (LAS float*)(lds + ATT_BIAS_OFF);
    for (int i = tid; i < 8 * 257; i += 512) biasl[i] = bt[i];
    __syncthreads();
    const int G = gridDim.x;
    for (int it = blockIdx.x; it < 2560; it += G) {
        if (it < 1280) {
            int seq_tok0, S, hb, q0;
            if (it < 256) { hb = it & 7; q0 = (it >> 3) * 256; seq_tok0 = T_P; S = 8192; }
            else { const int i2 = it - 256, r = i2 >> 8, c = i2 & 255, xcd = c & 7, j = c >> 3; const int pair = r * 32 + xcd * 4 + (j >> 3);
                   q0 = (j & 7) * 256; hb = pair & 7; seq_tok0 = (pair >> 3) * 2048; S = 2048; }
            const int qpos = q0 + wid * 32 + lq;
            const size_t qt = (size_t)(seq_tok0 + qpos);
            attn_item<false>(lds, QB + qt * NQ + hb * 192, KVB + hb * 256, NKV, KR, KVB + hb * 256 + 128, NKV, ATT + qt * DM + 1024 + hb * 128,
                             rope + (size_t)qpos * 64, biasl, 0.f, seq_tok0, S, qpos, 0, S / 64);
        } else {
            const int i2 = it - 1280, kvh = i2 & 1, qb = i2 >> 1;
            const int tokb = qb * 64;
            const int seq_tok0 = tokb < T_P ? (tokb & ~2047) : T_P;
            const int S = tokb < T_P ? 2048 : 8192;
            const int q0 = tokb - seq_tok0;
            const int head = kvh * 4 + (wid >> 1);
            const int qpos = q0 + (wid & 1) * 32 + lq;
            const size_t qt = (size_t)(seq_tok0 + qpos);
            attn_item<true>(lds, H + qt * INC + head * 128, H + 1024 + kvh * 128, INC, nullptr, H + 1280 + kvh * 128, INC, ATT + qt * DM + head * 128,
                            nullptr, biasl + head * 257 + 128, p.sink[layer * 8 + head] * LOG2E, seq_tok0, S, qpos, q0 - 128, 5);
        }
    }
}

__global__ void __launch_bounds__(512, 2) hymba_fwd(Params p) {
    extern __shared__ __attribute__((aligned(16))) unsigned char lds_raw[];
    LAS unsigned char* lds = (LAS unsigned char*)lds_raw;
    cg::grid_group grid = cg::this_grid();
    unsigned char* ws = p.ws;
    const int G = gridDim.x, bx = blockIdx.x;
    bf16_t* XB = (bf16_t*)(ws + WS_XB); bf16_t* H = (bf16_t*)(ws + WS_H); bf16_t* QB = (bf16_t*)(ws + WS_QB); bf16_t* KVB = (bf16_t*)(ws + WS_KVB);
    bf16_t* ATT = (bf16_t*)(ws + WS_ATT); bf16_t* KR = (bf16_t*)(ws + WS_KR); float* RINV = (float*)(ws + WS_RINV);
    bf16_t* GATED = (bf16_t*)(ws + WS_GATED); bf16_t* UCH = (bf16_t*)(ws + WS_UCH);
    const float* rope = (const float*)(ws + WS_ROPE);

    prologue(p, lds);
    grid.sync();

    for (int l = 0; l < DEPTH; ++l) {
        {
            pg8::Gemm g{XB, (const bf16_t*)(ws + WS_WIN) + (size_t)l * INCP * DM, T, INCP, DM, DM};
            pg8::StaticOrder S; S.init(T, INCP, G, bx);
            pg8::EpiBf16 E{H, INC, INC, nullptr};
            pg8::gemm_phase(lds, g, S, E);
        }
        grid.sync();
        prep_phase(H, RINV, KR, rope);
        grid.sync();
        {
            pg8::Gemm g{H + 1536, (const bf16_t*)(ws + WS_WUQ) + (size_t)l * NQ * QL, T, NQ, QL, INC};
            pg8::StaticOrder S; S.init(T, NQ, G, bx);
            pg8::EpiBf16 E{QB, NQ, NQ, RINV};
            pg8::gemm_phase(lds, g, S, E);
            pg8::Gemm g2{H + 2048, (const bf16_t*)(ws + WS_WUKV) + (size_t)l * NKV * KVL, T, NKV, KVL, INC};
            pg8::StaticOrder S2; S2.init(T, NKV, G, bx);
            pg8::EpiBf16 E2{KVB, NKV, NKV, RINV + 1};
            pg8::gemm_phase(lds, g2, S2, E2);
        }
        grid.sync();
        attn_phase(p, lds, l);
        grid.sync();
        {
            pg8::Gemm g{ATT, (const bf16_t*)(ws + WS_WO) + (size_t)l * DM * DM, T, DM, DM, DM};
            pg8::StaticOrder S; S.init(T, DM, G, bx);
            pg8::EpiResid E{p.out};
            pg8::gemm_phase(lds, g, S, E);
        }
        grid.sync();
        ln_phase(p.out, XB, p.ln1_g + l * DM, p.ln1_b + l * DM);
        grid.sync();
        for (int c = 0; c < NCHUNK; ++c) {
            {
                pg8::Gemm g{XB + (size_t)c * CHUNK * DM, (const bf16_t*)(ws + WS_WUP) + (size_t)l * DFF2 * DM, CHUNK, DFF2, DM, DM};
                pg8::StaticOrder S; S.init(CHUNK, DFF2, G, bx);
                pg8::EpiBf16 E{UCH, DFF2, DFF2, nullptr};
                pg8::gemm_phase(lds, g, S, E);
            }
            grid.sync();
            convglu_phase(UCH, GATED, c * CHUNK, p.conv_w + (size_t)l * 3 * DFF2, p.conv_b + (size_t)l * DFF2);
            grid.sync();
        }
        {
            pg8::Gemm g{GATED, (const bf16_t*)(ws + WS_WDN) + (size_t)l * DM * DFF, T, DM, DFF, DFF};
            pg8::StaticOrder S; S.init(T, DM, G, bx);
            pg8::EpiResid E{p.out};
            pg8::gemm_phase(lds, g, S, E);
        }
        grid.sync();
        ln_phase(p.out, XB, p.ln2_g + l * DM, p.ln2_b + l * DM);
        grid.sync();
    }
}

extern "C" void kernel_launch(void* const* d_in, const int* in_sizes, int n_in, void* d_out, int out_size, void* d_ws, size_t ws_size, hipStream_t stream) {
    static int grid_blocks = 0;
    if (grid_blocks == 0) {
        if (n_in != 18 || out_size != T * DM || ws_size < WS_END) { fprintf(stderr, "kernel_launch: unexpected shapes (n_in %d out %d ws %zu need %zu)\n", n_in, out_size, ws_size, (size_t)WS_END); grid_blocks = -1; return; }
        int dev = 0, cus = 0, per_cu = 0;
        (void)hipGetDevice(&dev);
        (void)hipDeviceGetAttribute(&cus, hipDeviceAttributeMultiprocessorCount, dev);
        if (hipFuncSetAttribute((const void*)hymba_fwd, hipFuncAttributeMaxDynamicSharedMemorySize, LDS_BYTES) != hipSuccess) { fprintf(stderr, "kernel_launch: hipFuncSetAttribute failed\n"); grid_blocks = -1; return; }
        if (hipOccupancyMaxActiveBlocksPerMultiprocessor(&per_cu, (const void*)hymba_fwd, 512, LDS_BYTES) != hipSuccess || per_cu < 1) { fprintf(stderr, "kernel_launch: occupancy query gave %d\n", per_cu); per_cu = 1; }
        (void)hipGetLastError();
        grid_blocks = cus * per_cu;
    }
    if (grid_blocks < 0) return;
    Params p{};
    p.x_prompt = (const float*)d_in[0]; p.x_sample = (const float*)d_in[1]; p.rel_bias = (const float*)d_in[2]; p.w_in = (const float*)d_in[3];
    p.sink = (const float*)d_in[4]; p.q_norm_g = (const float*)d_in[5]; p.w_uq = (const float*)d_in[6]; p.kv_norm_g = (const float*)d_in[7];
    p.w_ukv = (const float*)d_in[8]; p.w_o = (const float*)d_in[9]; p.ln1_g = (const float*)d_in[10]; p.ln1_b = (const float*)d_in[11];
    p.w_up = (const float*)d_in[12]; p.conv_w = (const float*)d_in[13]; p.conv_b = (const float*)d_in[14]; p.w_down = (const float*)d_in[15];
    p.ln2_g = (const float*)d_in[16]; p.ln2_b = (const float*)d_in[17];
    p.out = (float*)d_out; p.ws = (unsigned char*)d_ws;
    void* args[] = {&p};
    hipError_t e = hipLaunchCooperativeKernel((const void*)hymba_fwd, dim3(grid_blocks), dim3(512), args, LDS_BYTES, stream);
    if (e != hipSuccess) fprintf(stderr, "cooperative launch failed: %s (grid %d)\n", hipGetErrorString(e), grid_blocks);
}
```
